# Optimizing an MI355X kernel written in HIP

```python
import jax, jax.numpy as jnp
from jax import lax
import numpy as np

D_MODEL = 1024
BATCH = 8
SEQ = 2048
DEPTH = 1
DEC_BATCH = 128
DEC_SEQ = 8
PAST_LEN = 16384
PAGE_SIZE = 128

MIX_WIDTH = D_MODEL
SGU_WIDTH = MIX_WIDTH // 2
CONV_WIDTH = MIX_WIDTH - SGU_WIDTH
SGU_HEADS = 4
SGU_HEAD_DIM = SGU_WIDTH // SGU_HEADS
CHUNK = 128
CONV_K = 31
MEM_TOKENS = 256
X_HEADS = 4
X_HEAD_DIM = D_MODEL // X_HEADS
FFN_DIM = 4 * D_MODEL
IN_COLS = 2 * SGU_WIDTH + 2 * CONV_WIDTH
EPS = 1e-6

kernel_name = 'hymba_sgu_conformer_macaron_decoder_step'


def rms_norm(x, g):
    xf = x.astype(jnp.float32)
    y = xf * lax.rsqrt(jnp.mean(xf * xf, axis=-1, keepdims=True) + EPS)
    return (y * g.astype(jnp.float32)).astype(x.dtype)


def layer_norm(x, g, b):
    xf = x.astype(jnp.float32)
    mu = jnp.mean(xf, axis=-1, keepdims=True)
    xc = xf - mu
    y = xc * lax.rsqrt(jnp.mean(xc * xc, axis=-1, keepdims=True) + EPS)
    return (y * g.astype(jnp.float32) + b.astype(jnp.float32)).astype(x.dtype)


def macaron_ffn(x, g_pre, w_gate, w_up, w_down, g_post):
    n = rms_norm(x, g_pre)
    f = (jax.nn.silu(n @ w_gate) * (n @ w_up)) @ w_down
    return x + 0.5 * rms_norm(f, g_post)


def spatial_gate(u, v, w_s, b_s):
    bsz, L, _ = v.shape
    n_chunks = -(-L // CHUNK)
    pad = n_chunks * CHUNK - L
    vp = jnp.pad(v, ((0, 0), (0, pad), (0, 0))).reshape(bsz, n_chunks, CHUNK, SGU_HEADS, SGU_HEAD_DIM)
    causal = jnp.tril(jnp.ones((CHUNK, CHUNK), dtype=bool))
    ws = jnp.where(causal, w_s, jnp.zeros_like(w_s))
    s = jnp.einsum('hij,bnjhd->bnihd', ws, vp) + b_s.T[:, :, None]
    s = s.reshape(bsz, n_chunks * CHUNK, SGU_WIDTH)[:, :L]
    return u * s


def causal_dwconv(a, left, w, b):
    full = jnp.concatenate([left, a], axis=1)
    y = lax.conv_general_dilated(full, w[:, None, :], window_strides=(1,), padding='VALID',
                                 dimension_numbers=('NWC', 'WIO', 'NWC'),
                                 feature_group_count=a.shape[-1])
    return y + b, full[:, -(CONV_K - 1):]


def token_mixing(h, conv_left, g_pre, w_in, sgu_ln_g, sgu_ln_b, w_s, b_s,
                 conv_w, conv_b, conv_ln_g, conv_ln_b, w_out, g_post):
    n = rms_norm(h, g_pre)
    z = n @ w_in
    u, v, a, gate = jnp.split(z, [SGU_WIDTH, 2 * SGU_WIDTH, 2 * SGU_WIDTH + CONV_WIDTH], axis=-1)
    v = layer_norm(v, sgu_ln_g, sgu_ln_b)
    out_a = spatial_gate(u, v, w_s, b_s)
    glu = a * jax.nn.sigmoid(gate)
    c, conv_state = causal_dwconv(glu, conv_left, conv_w, conv_b)
    out_b = jax.nn.silu(layer_norm(c, conv_ln_g, conv_ln_b))
    o = jnp.concatenate([out_a, out_b], axis=-1) @ w_out
    L = v.shape[1]
    rows = L - ((L - 1) // CHUNK) * CHUNK
    return h + rms_norm(o, g_post), conv_state, v[:, L - rows:]


def memory_kv(mem, g_mem, w_k, w_v):
    bsz, m, _ = mem.shape
    mn = rms_norm(mem, g_mem)
    k = (mn @ w_k).reshape(bsz, m, X_HEADS, X_HEAD_DIM)
    v = (mn @ w_v).reshape(bsz, m, X_HEADS, X_HEAD_DIM)
    return k, v


def cross_attend(h, k, v, g_pre, w_q, w_o, g_post):
    bsz, L, _ = h.shape
    n = rms_norm(h, g_pre)
    q = (n @ w_q).reshape(bsz, L, X_HEADS, X_HEAD_DIM)
    s = jnp.einsum('blhd,bmhd->bhlm', q, k).astype(jnp.float32) * (X_HEAD_DIM ** -0.5)
    p = jax.nn.softmax(s, axis=-1).astype(v.dtype)
    o = jnp.einsum('bhlm,bmhd->blhd', p, v).reshape(bsz, L, X_HEADS * X_HEAD_DIM)
    return h + rms_norm(o @ w_o, g_post)


def setup_inputs(seed: int = 0) -> dict:
    key = jax.random.key(seed)
    ks = iter(jax.random.split(key, 48))

    def nrm(shape, scale):
        return jax.random.normal(next(ks), shape, jnp.float32) * scale

    def gain(shape):
        return 1.0 + nrm(shape, 0.02)

    L = DEPTH
    d = D_MODEL
    return {
        'x_prompt': nrm((BATCH, SEQ, d), 1.0),
        'x_sample': nrm((DEC_BATCH, DEC_SEQ, d), 1.0),
        'mem_prompt': nrm((BATCH, MEM_TOKENS, d), 1.0),
        'cache_mem_k': nrm((L, DEC_BATCH, MEM_TOKENS, X_HEADS, X_HEAD_DIM), 1.0),
        'cache_mem_v': nrm((L, DEC_BATCH, MEM_TOKENS, X_HEADS, X_HEAD_DIM), 1.0),
        'state_conv': nrm((L, DEC_BATCH, CONV_K - 1, CONV_WIDTH), 0.5),
        'ffn1_g_pre': gain((L, d)),
        'ffn1_w_gate': nrm((L, d, FFN_DIM), d ** -0.5),
        'ffn1_w_up': nrm((L, d, FFN_DIM), d ** -0.5),
        'ffn1_w_down': nrm((L, FFN_DIM, d), FFN_DIM ** -0.5),
        'ffn1_g_post': gain((L, d)),
        'mix_g_pre': gain((L, d)),
        'mix_w_in': nrm((L, d, IN_COLS), d ** -0.5),
        'sgu_ln_g': gain((L, SGU_WIDTH)),
        'sgu_ln_b': nrm((L, SGU_WIDTH), 0.02),
        'sgu_w_s': nrm((L, SGU_HEADS, CHUNK, CHUNK), CHUNK ** -0.5),
        'sgu_b_s': 1.0 + nrm((L, SGU_HEADS, CHUNK), 0.02),
        'conv_w': nrm((L, CONV_K, CONV_WIDTH), CONV_K ** -0.5),
        'conv_b': nrm((L, CONV_WIDTH), 0.02),
        'conv_ln_g': gain((L, CONV_WIDTH)),
        'conv_ln_b': nrm((L, CONV_WIDTH), 0.02),
        'mix_w_out': nrm((L, MIX_WIDTH, d), MIX_WIDTH ** -0.5),
        'mix_g_post': gain((L, d)),
        'mem_g': gain((L, d)),
        'xattn_g_pre': gain((L, d)),
        'xattn_w_q': nrm((L, d, X_HEADS * X_HEAD_DIM), d ** -0.5),
        'xattn_w_k': nrm((L, d, X_HEADS * X_HEAD_DIM), d ** -0.5),
        'xattn_w_v': nrm((L, d, X_HEADS * X_HEAD_DIM), d ** -0.5),
        'xattn_w_o': nrm((L, X_HEADS * X_HEAD_DIM, d), (X_HEADS * X_HEAD_DIM) ** -0.5),
        'xattn_g_post': gain((L, d)),
        'ffn2_g_pre': gain((L, d)),
        'ffn2_w_gate': nrm((L, d, FFN_DIM), d ** -0.5),
        'ffn2_w_up': nrm((L, d, FFN_DIM), d ** -0.5),
        'ffn2_w_down': nrm((L, FFN_DIM, d), FFN_DIM ** -0.5),
        'ffn2_g_post': gain((L, d)),
    }


def reference(x_prompt, x_sample, mem_prompt, cache_mem_k, cache_mem_v, state_conv,
              ffn1_g_pre, ffn1_w_gate, ffn1_w_up, ffn1_w_down, ffn1_g_post,
              mix_g_pre, mix_w_in, sgu_ln_g, sgu_ln_b, sgu_w_s, sgu_b_s,
              conv_w, conv_b, conv_ln_g, conv_ln_b, mix_w_out, mix_g_post,
              mem_g, xattn_g_pre, xattn_w_q, xattn_w_k, xattn_w_v, xattn_w_o, xattn_g_post,
              ffn2_g_pre, ffn2_w_gate, ffn2_w_up, ffn2_w_down, ffn2_g_post):

    def run_layer(x, conv_left, mem_k, mem_v, l):
        h = macaron_ffn(x, ffn1_g_pre[l], ffn1_w_gate[l], ffn1_w_up[l], ffn1_w_down[l], ffn1_g_post[l])
        h, conv_state, chunk_v = token_mixing(
            h, conv_left, mix_g_pre[l], mix_w_in[l], sgu_ln_g[l], sgu_ln_b[l], sgu_w_s[l], sgu_b_s[l],
            conv_w[l], conv_b[l], conv_ln_g[l], conv_ln_b[l], mix_w_out[l], mix_g_post[l])
        h = cross_attend(h, mem_k, mem_v, xattn_g_pre[l], xattn_w_q[l], xattn_w_o[l], xattn_g_post[l])
        h = macaron_ffn(h, ffn2_g_pre[l], ffn2_w_gate[l], ffn2_w_up[l], ffn2_w_down[l], ffn2_g_post[l])
        return h, conv_state, chunk_v

    hp, hs = x_prompt, x_sample
    mk_p, mv_p, cs_p, cs_s, cv_p, cv_s = [], [], [], [], [], []
    for l in range(DEPTH):
        k_p, v_p = memory_kv(mem_prompt, mem_g[l], xattn_w_k[l], xattn_w_v[l])
        left_p = jnp.zeros((hp.shape[0], CONV_K - 1, CONV_WIDTH), hp.dtype)
        hp, conv_p, chunk_p = run_layer(hp, left_p, k_p, v_p, l)
        hs, conv_s, chunk_s = run_layer(hs, state_conv[l], cache_mem_k[l], cache_mem_v[l], l)
        mk_p.append(k_p)
        mv_p.append(v_p)
        cs_p.append(conv_p)
        cs_s.append(conv_s)
        cv_p.append(chunk_p)
        cv_s.append(chunk_s)

    return (hp, hs, jnp.stack(mk_p), jnp.stack(mv_p), jnp.stack(cs_p), jnp.stack(cs_s),
            jnp.stack(cv_p), jnp.stack(cv_s))
```

```cpp
#include <hip/hip_runtime.h>
#include <hip/hip_cooperative_groups.h>
#include <cstdio>
namespace cg = cooperative_groups;

#ifndef SINGLE_LAUNCH
#define SINGLE_LAUNCH 0
#endif

#define LAS __attribute__((address_space(3)))
typedef unsigned short bf16_t;
typedef short bf16x8 __attribute__((ext_vector_type(8)));
typedef float f32x4 __attribute__((ext_vector_type(4)));
typedef unsigned u32x2 __attribute__((ext_vector_type(2)));
typedef unsigned u32x4 __attribute__((ext_vector_type(4)));

constexpr int TP = 16384, TS = 1024, T = TP + TS, D = 1024, FF = 4096;
constexpr int NTHR = 512;
constexpr int BK = 64, HALF = 128, HTB = HALF * BK * 2, STAGE_BYTES = 8 * HTB, NXCD = 8, WGM = 8;
constexpr int LDS_BYTES = 147456;
constexpr float EPS = 1e-6f;

constexpr size_t O_Y = 0;
constexpr size_t O_MK = (size_t)T * D;
constexpr size_t O_MV = O_MK + 2048ull * 1024;
constexpr size_t O_CSP = O_MV + 2048ull * 1024;
constexpr size_t O_CSS = O_CSP + 8ull * 30 * 512;
constexpr size_t O_CVP = O_CSS + 128ull * 30 * 512;
constexpr size_t O_CVS = O_CVP + 8ull * 128 * 512;

constexpr size_t MiB = 1ull << 20;
constexpr size_t WS_WGU1 = 0;
constexpr size_t WS_WD1 = WS_WGU1 + 16 * MiB;
constexpr size_t WS_WGU2 = WS_WD1 + 8 * MiB;
constexpr size_t WS_WD2 = WS_WGU2 + 16 * MiB;
constexpr size_t WS_WIN = WS_WD2 + 8 * MiB;
constexpr size_t WS_WOUT = WS_WIN + 4 * MiB;
constexpr size_t WS_WQ = WS_WOUT + 2 * MiB;
constexpr size_t WS_WKV = WS_WQ + 2 * MiB;
constexpr size_t WS_WO = WS_WKV + 4 * MiB;
constexpr size_t WS_WS = WS_WO + 2 * MiB;
constexpr size_t WS_XN = WS_WS + 1 * MiB;
constexpr size_t WS_MN = WS_XN + 34 * MiB;
constexpr size_t WS_KP = WS_MN + 4 * MiB;
constexpr size_t WS_VPT = WS_KP + 4 * MiB;
constexpr size_t WS_F = WS_VPT + 4 * MiB;
constexpr size_t WS_H = WS_F + 68 * MiB;
constexpr size_t WS_Z = WS_H;
constexpr size_t WS_MIXO = WS_H + 68 * MiB;
constexpr size_t WS_Q = WS_H;
constexpr size_t WS_P = WS_H + 34 * MiB;
constexpr size_t WS_AO = WS_H + 68 * MiB;
constexpr size_t WS_END = WS_H + 136 * MiB;

struct Params {
    const float* in[35];
    float* out;
    unsigned char* ws;
    int ph_lo, ph_hi;
};

__device__ __forceinline__ unsigned cvt_pk_bf16(float lo, float hi) { unsigned r; asm("v_cvt_pk_bf16_f32 %0, %1, %2" : "=v"(r) : "v"(lo), "v"(hi)); return r; }
__device__ __forceinline__ float bflo(unsigned u) { return __uint_as_float(u << 16); }
__device__ __forceinline__ float bfhi(unsigned u) { return __uint_as_float(u & 0xffff0000u); }
__device__ __forceinline__ float bf2f(bf16_t b) { return __uint_as_float(((unsigned)b) << 16); }
__device__ __forceinline__ bf16_t f2bf(float f) { return (bf16_t)(cvt_pk_bf16(f, 0.f) & 0xffffu); }
__device__ __forceinline__ float wave_sum(float v) {
#pragma unroll
    for (int o = 32; o >= 1; o >>= 1) v += __shfl_xor(v, o);
    return v;
}
__device__ __forceinline__ float wave_max(float v) {
#pragma unroll
    for (int o = 32; o >= 1; o >>= 1) v = fmaxf(v, __shfl_xor(v, o));
    return v;
}
__device__ __forceinline__ int lane_id_() { return (int)__builtin_amdgcn_mbcnt_hi(~0u, __builtin_amdgcn_mbcnt_lo(~0u, 0u)); }
__device__ __forceinline__ float sigmoidf_(float x) { return __builtin_amdgcn_rcpf(1.f + __expf(-x)); }
__device__ __forceinline__ float siluf_(float x) { return x * sigmoidf_(x); }

__device__ __forceinline__ int lds_byte(int r, int c) { const int st = (r >> 4) * 2 + (c >> 5), rr = r & 15, cc = c & 31, ob = rr * 64 + cc * 2; return st * 1024 + (ob ^ (((ob >> 9) & 1) << 5)); }
__device__ __forceinline__ void stage_rc(int b, int& R, int& C) { const int st = b / 1024, sb = b % 1024, swz = sb ^ (((sb >> 9) & 1) << 5); R = (st >> 1) * 16 + swz / 64; C = (st & 1) * 32 + (swz % 64) / 2; }

struct UnitInfo { const char* A; const char* B; int r0, c0, z; };
struct GemmP { int K; unsigned lda, ldb; size_t hstepA, hstepB; };
struct Sched {
    const char* A; const char* B;
    long tstepA, tstepB, zA0, zA1, zB0, zB1;
    int nM, nN, nZ, zsplit, G, c;
    __device__ __forceinline__ bool next(int i, UnitInfo& u) const {
        const long L = (long)i * G + c; const int nwg = nM * nN;
        if (L >= (long)nwg * nZ) return false;
        const int z = (int)(L / nwg); int wgid = (int)(L % nwg);
        { const int q = nwg / NXCD, r = nwg % NXCD, xcd = wgid % NXCD, off = wgid / NXCD; wgid = (xcd < r ? xcd * (q + 1) : r * (q + 1) + (xcd - r) * q) + off; }
        const int nig = WGM * nN, gid = wgid / nig, fm = gid * WGM, gsz = (nM - fm) < WGM ? (nM - fm) : WGM;
        const int pm = fm + ((wgid % nig) % gsz), pn = (wgid % nig) / gsz;
        const int z0 = z / zsplit, z1 = z % zsplit;
        u.r0 = pm * 256; u.c0 = pn * 256; u.z = z;
        u.A = A + (long)z0 * zA0 + (long)z1 * zA1 + (long)pm * tstepA;
        u.B = B + (long)z0 * zB0 + (long)z1 * zB1 + (long)pn * tstepB;
        return true;
    }
};

#define G_SA(b, h) (((b) * 2 + (h)) * HTB)
#define G_SB(b, h) ((4 + (b) * 2 + (h)) * HTB)
#define G_STAGE(bufoff, gbase, voff) do { _Pragma("unroll") for (int _i = 0; _i < 2; ++_i) \
        __builtin_amdgcn_global_load_lds((const unsigned*)((const char*)(gbase) + (voff)[_i]), (LAS unsigned*)(lds + (bufoff) + ldsw + _i * 8192), 16, 0, 0); } while (0)
#define G_LDA(dst, b, h) do { _Pragma("unroll") for (int m = 0; m < 4; ++m) _Pragma("unroll") for (int k = 0; k < 2; ++k) dst[m][k] = *(const LAS bf16x8*)(lds + G_SA(b, h) + aoff + m * 2048 + k * 1024); } while (0)
#define G_LDB(dst, b, h) do { _Pragma("unroll") for (int n = 0; n < 2; ++n) _Pragma("unroll") for (int k = 0; k < 2; ++k) dst[n][k] = *(const LAS bf16x8*)(lds + G_SB(b, h) + boff + n * 2048 + k * 1024); } while (0)
#define G_MMA(ai, bj, At, Bt) do { __builtin_amdgcn_s_setprio(1); _Pragma("unroll") for (int m = 0; m < 4; ++m) _Pragma("unroll") for (int n = 0; n < 2; ++n) _Pragma("unroll") for (int k = 0; k < 2; ++k) \
        acc[ai][bj][m][n] = __builtin_amdgcn_mfma_f32_16x16x32_bf16(Bt[n][k], At[m][k], acc[ai][bj][m][n], 0, 0, 0); __builtin_amdgcn_s_setprio(0); } while (0)
#define G_WAIT_V(n) asm volatile("s_waitcnt vmcnt(" #n ")" ::: "memory")
#define G_WAIT_L(n) asm volatile("s_waitcnt lgkmcnt(" #n ")" ::: "memory")
#define G_BAR __builtin_amdgcn_s_barrier()
#define G_SCHED __builtin_amdgcn_sched_barrier(0)

template <class Epi>
__device__ __forceinline__ void gemm_phase(const int wid_, LAS unsigned char* lds, const GemmP g, const Sched& S, const Epi& E) {
    const int wid = wid_, lane = lane_id_(), tid = wid * 64 + lane, wr = wid >> 2, wc = wid & 3, fr = lane & 15, fq = lane >> 4;
    const int nt = g.K / BK;
    unsigned voffA[2], voffB[2];
#pragma unroll
    for (int i = 0; i < 2; ++i) { int R, C; stage_rc(tid * 16 + i * 8192, R, C);
        voffA[i] = (unsigned)(R * g.lda + C) * 2u; voffB[i] = (unsigned)(R * g.ldb + C) * 2u; }
    const size_t kstep = (size_t)(BK * 2);
    const size_t hstepA = g.hstepA, hstepB = g.hstepB;
    const unsigned ldsw = (unsigned)wid * 1024u;
    const int aoff = lds_byte(wr * 64 + fr, fq * 8), boff = lds_byte(wc * 32 + fr, fq * 8);
    UnitInfo cur, nxt; int ui = 0;
    if (!S.next(0, cur)) return;
    f32x4 acc[2][2][4][2];
#pragma unroll
    for (int a = 0; a < 2; ++a)
#pragma unroll
        for (int b = 0; b < 2; ++b)
#pragma unroll
            for (int m = 0; m < 4; ++m)
#pragma unroll
                for (int n = 0; n < 2; ++n) acc[a][b][m][n] = (f32x4){0.f, 0.f, 0.f, 0.f};
    bf16x8 At[4][2], B0[2][2], B1[2][2];
    const char* cA = cur.A; const char* cB = cur.B;
    G_STAGE(G_SB(0, 0), cB, voffB); G_STAGE(G_SA(0, 0), cA, voffA); G_STAGE(G_SB(0, 1), cB + hstepB, voffB); G_STAGE(G_SA(0, 1), cA + hstepA, voffA);
    if (wr == 1) G_BAR;
    G_WAIT_V(4); G_BAR;
    G_STAGE(G_SB(1, 0), cB + kstep, voffB); G_STAGE(G_SA(1, 0), cA + kstep, voffA); G_STAGE(G_SB(1, 1), cB + hstepB + kstep, voffB);
    G_WAIT_V(6); G_BAR;
    for (;;) {
        const bool has_next = S.next(ui + 1, nxt);
        const char* nA = has_next ? nxt.A : cA; const char* nB = has_next ? nxt.B : cB;
        for (int t = 0; t < nt; t += 2) {
            const bool last = (t == nt - 2);
            const char* a1 = cA + (size_t)(t + 1) * kstep;
            const char* a2 = last ? nA : cA + (size_t)(t + 2) * kstep; const char* b2 = last ? nB : cB + (size_t)(t + 2) * kstep;
            const char* a3 = a2 + kstep; const char* b3 = b2 + kstep;
            G_LDB(B0, 0, 0); G_SCHED; G_LDA(At, 0, 0); G_STAGE(G_SA(1, 1), a1 + hstepA, voffA);
            G_WAIT_L(8); G_BAR; G_WAIT_L(0); G_MMA(0, 0, At, B0); G_BAR; G_SCHED;
            G_LDB(B1, 0, 1); G_STAGE(G_SB(0, 0), b2, voffB);
            G_BAR; G_WAIT_L(0); G_MMA(0, 1, At, B1); G_BAR;
            G_LDA(At, 0, 1); G_STAGE(G_SA(0, 0), a2, voffA);
            G_BAR; G_WAIT_L(0); G_MMA(1, 0, At, B0); G_BAR; G_SCHED;
            G_STAGE(G_SB(0, 1), b2 + hstepB, voffB);
            G_WAIT_V(6); G_BAR; G_MMA(1, 1, At, B1); G_BAR;
            G_LDB(B0, 1, 0); G_SCHED; G_LDA(At, 1, 0); G_STAGE(G_SA(0, 1), a2 + hstepA, voffA);
            G_WAIT_L(8); G_BAR; G_WAIT_L(0); G_MMA(0, 0, At, B0); G_BAR; G_SCHED;
            G_LDB(B1, 1, 1); G_STAGE(G_SB(1, 0), b3, voffB);
            G_BAR; G_WAIT_L(0); G_MMA(0, 1, At, B1); G_BAR;
            G_LDA(At, 1, 1); G_STAGE(G_SA(1, 0), a3, voffA);
            G_BAR; G_WAIT_L(0); G_MMA(1, 0, At, B0); G_BAR; G_SCHED;
            G_STAGE(G_SB(1, 1), b3 + hstepB, voffB);
            G_WAIT_V(6); G_BAR; G_MMA(1, 1, At, B1); G_BAR;
        }
        E(acc, cur, wr, wc, fr, fq, lds + STAGE_BYTES);
        if (!has_next) break;
#pragma unroll
        for (int a = 0; a < 2; ++a)
#pragma unroll
            for (int b = 0; b < 2; ++b)
#pragma unroll
                for (int m = 0; m < 4; ++m)
#pragma unroll
                    for (int n = 0; n < 2; ++n) acc[a][b][m][n] = (f32x4){0.f, 0.f, 0.f, 0.f};
        cur = nxt; cA = nA; cB = nB; ++ui;
    }
    G_WAIT_V(0);
    if (wr == 0) G_BAR;
    G_BAR;
}

typedef f32x4 AccT[2][2][4][2];

struct EpiSilu {
    bf16_t* H; int ldc;
    __device__ __forceinline__ void operator()(AccT& acc, const UnitInfo& u, int wr, int wc, int fr, int fq, LAS unsigned char*) const {
        const int row0 = u.r0 + wr * 64 + fr, col0 = (u.c0 >> 1) + wc * 32 + 4 * fq;
#pragma unroll
        for (int ai = 0; ai < 2; ++ai)
#pragma unroll
            for (int m = 0; m < 4; ++m) { bf16_t* rowp = H + (size_t)(row0 + ai * HALF + m * 16) * ldc + col0;
#pragma unroll
                for (int n = 0; n < 2; ++n) { const f32x4 gt = acc[ai][0][m][n], up = acc[ai][1][m][n];
                    u32x2 o; o.x = cvt_pk_bf16(siluf_(gt[0]) * up[0], siluf_(gt[1]) * up[1]); o.y = cvt_pk_bf16(siluf_(gt[2]) * up[2], siluf_(gt[3]) * up[3]);
                    *(u32x2*)(rowp + n * 16) = o; } }
    }
};
struct EpiF32 {
    float* C; int ldc;
    __device__ __forceinline__ void operator()(AccT& acc, const UnitInfo& u, int wr, int wc, int fr, int fq, LAS unsigned char*) const {
        const int row0 = u.r0 + wr * 64 + fr, col0 = u.c0 + wc * 32 + 4 * fq;
#pragma unroll
        for (int ai = 0; ai < 2; ++ai)
#pragma unroll
            for (int m = 0; m < 4; ++m) { float* rowp = C + (size_t)(row0 + ai * HALF + m * 16) * ldc + col0;
#pragma unroll
                for (int bj = 0; bj < 2; ++bj)
#pragma unroll
                    for (int n = 0; n < 2; ++n) *(f32x4*)(rowp + bj * HALF + n * 16) = acc[ai][bj][m][n]; }
    }
};
struct EpiBf16 {
    bf16_t* O; int ldc; long zO0, zO1; int zsplit;
    __device__ __forceinline__ void operator()(AccT& acc, const UnitInfo& u, int wr, int wc, int fr, int fq, LAS unsigned char*) const {
        const int row0 = u.r0 + wr * 64 + fr, col0 = u.c0 + wc * 32 + 4 * fq;
        bf16_t* base = O + (long)(u.z / zsplit) * zO0 + (long)(u.z % zsplit) * zO1;
#pragma unroll
        for (int ai = 0; ai < 2; ++ai)
#pragma unroll
            for (int m = 0; m < 4; ++m) { bf16_t* rowp = base + (size_t)(row0 + ai * HALF + m * 16) * ldc + col0;
#pragma unroll
                for (int bj = 0; bj < 2; ++bj)
#pragma unroll
                    for (int n = 0; n < 2; ++n) { const f32x4 v = acc[ai][bj][m][n]; u32x2 o; o.x = cvt_pk_bf16(v[0], v[1]); o.y = cvt_pk_bf16(v[2], v[3]);
                        *(u32x2*)(rowp + bj * HALF + n * 16) = o; } }
    }
};
struct EpiKV {
    float* outk; float* outv; bf16_t* KP; bf16_t* VPT;
    __device__ __forceinline__ void operator()(AccT& acc, const UnitInfo& u, int wr, int wc, int fr, int fq, LAS unsigned char*) const {
        const int row0 = u.r0 + wr * 64 + fr, col0 = u.c0 + wc * 32 + 4 * fq;
        const bool isV = u.c0 >= 1024;
#pragma unroll
        for (int ai = 0; ai < 2; ++ai)
#pragma unroll
            for (int m = 0; m < 4; ++m) { const int row = row0 + ai * HALF + m * 16;
#pragma unroll
                for (int bj = 0; bj < 2; ++bj)
#pragma unroll
                    for (int n = 0; n < 2; ++n) { const f32x4 v = acc[ai][bj][m][n]; const int col = col0 + bj * HALF + n * 16;
                        if (!isV) { *(f32x4*)(outk + (size_t)row * 1024 + col) = v; u32x2 o; o.x = cvt_pk_bf16(v[0], v[1]); o.y = cvt_pk_bf16(v[2], v[3]); *(u32x2*)(KP + (size_t)row * 1024 + col) = o; }
                        else { const int c = col - 1024; *(f32x4*)(outv + (size_t)row * 1024 + c) = v;
                            const int bb = row >> 8, mm = row & 255, hh = c >> 8, dd = c & 255;
                            bf16_t* vp = VPT + ((size_t)((bb * 4 + hh) * 256 + dd)) * 256 + mm;
                            vp[0] = f2bf(v[0]); vp[256] = f2bf(v[1]); vp[512] = f2bf(v[2]); vp[768] = f2bf(v[3]); } } }
    }
};
struct EpiSoftmax {
    bf16_t* P;
    __device__ __forceinline__ void operator()(AccT& acc, const UnitInfo& u, int wr, int wc, int fr, int fq, LAS unsigned char* xl) const {
        LAS float* redmax = (LAS float*)xl; LAS float* redsum = redmax + 1024;
        const float kk = 0.0625f * 1.4426950408889634f;
#pragma unroll
        for (int ai = 0; ai < 2; ++ai)
#pragma unroll
            for (int m = 0; m < 4; ++m) { float mx = -3.0e38f;
#pragma unroll
                for (int bj = 0; bj < 2; ++bj)
#pragma unroll
                    for (int n = 0; n < 2; ++n) { const f32x4 v = acc[ai][bj][m][n]; mx = fmaxf(mx, fmaxf(fmaxf(v[0], v[1]), fmaxf(v[2], v[3]))); }
                mx = fmaxf(mx, __shfl_xor(mx, 16)); mx = fmaxf(mx, __shfl_xor(mx, 32));
                const int rl = ai * 128 + wr * 64 + m * 16 + fr;
                if (fq == 0) redmax[rl * 4 + wc] = mx; }
        asm volatile("s_waitcnt lgkmcnt(0)" ::: "memory"); __builtin_amdgcn_s_barrier(); asm volatile("" ::: "memory");
#pragma unroll
        for (int ai = 0; ai < 2; ++ai)
#pragma unroll
            for (int m = 0; m < 4; ++m) { const int rl = ai * 128 + wr * 64 + m * 16 + fr;
                const f32x4 q = *(const LAS f32x4*)(redmax + rl * 4); const float mx = fmaxf(fmaxf(q[0], q[1]), fmaxf(q[2], q[3])) * kk;
                float sm = 0.f;
#pragma unroll
                for (int bj = 0; bj < 2; ++bj)
#pragma unroll
                    for (int n = 0; n < 2; ++n) { f32x4 v = acc[ai][bj][m][n];
#pragma unroll
                        for (int j = 0; j < 4; ++j) { v[j] = __builtin_amdgcn_exp2f(v[j] * kk - mx); sm += v[j]; }
                        acc[ai][bj][m][n] = v; }
                sm += __shfl_xor(sm, 16); sm += __shfl_xor(sm, 32);
                if (fq == 0) redsum[rl * 4 + wc] = sm; __builtin_amdgcn_sched_barrier(0); }
        asm volatile("s_waitcnt lgkmcnt(0)" ::: "memory"); __builtin_amdgcn_s_barrier(); asm volatile("" ::: "memory");
        const int bb = u.z >> 2, hh = u.z & 3;
        const int row0 = u.r0 + wr * 64 + fr, col0 = hh * 256 + wc * 32 + 4 * fq;
#pragma unroll
        for (int ai = 0; ai < 2; ++ai)
#pragma unroll
            for (int m = 0; m < 4; ++m) { const int rl = ai * 128 + wr * 64 + m * 16 + fr;
                const f32x4 q = *(const LAS f32x4*)(redsum + rl * 4); const float inv = 1.f / (q[0] + q[1] + q[2] + q[3]);
                bf16_t* rowp = P + ((size_t)bb * 2048 + row0 + ai * HALF + m * 16) * 1024 + col0;
#pragma unroll
                for (int bj = 0; bj < 2; ++bj)
#pragma unroll
                    for (int n = 0; n < 2; ++n) { const f32x4 v = acc[ai][bj][m][n]; u32x2 o; o.x = cvt_pk_bf16(v[0] * inv, v[1] * inv); o.y = cvt_pk_bf16(v[2] * inv, v[3] * inv);
                        *(u32x2*)(rowp + bj * HALF + n * 16) = o; } __builtin_amdgcn_sched_barrier(0); }
    }
};

__device__ void transpose_w(const int wid_, LAS unsigned char* lds, const float* __restrict__ W, bf16_t* __restrict__ Wt, int K, int N) {
    LAS float* tile = (LAS float*)lds;
    const int tid = (wid_ * 64 + lane_id_()), tn = N / 64, ntile = (K / 64) * tn;
    for (int t = blockIdx.x; t < ntile; t += gridDim.x) {
        const int k0 = (t / tn) * 64, n0 = (t % tn) * 64;
#pragma unroll
        for (int p = 0; p < 2; ++p) { const int k = p * 32 + (tid >> 4), n4 = (tid & 15) * 4;
            const f32x4 v = *(const f32x4*)(W + (size_t)(k0 + k) * N + n0 + n4);
            tile[k * 65 + n4 + 0] = v[0]; tile[k * 65 + n4 + 1] = v[1]; tile[k * 65 + n4 + 2] = v[2]; tile[k * 65 + n4 + 3] = v[3]; }
        __syncthreads();
        { const int n = tid >> 3, k8 = (tid & 7) * 8; float f[8];
#pragma unroll
            for (int e = 0; e < 8; ++e) f[e] = tile[(k8 + e) * 65 + n];
            u32x4 o; o.x = cvt_pk_bf16(f[0], f[1]); o.y = cvt_pk_bf16(f[2], f[3]); o.z = cvt_pk_bf16(f[4], f[5]); o.w = cvt_pk_bf16(f[6], f[7]);
            *(u32x4*)(Wt + (size_t)(n0 + n) * K + k0 + k8) = o; }
        __syncthreads();
    }
}
__device__ void norm_rows(const int wid_, const float* __restrict__ src, const float* __restrict__ g, bf16_t* __restrict__ dst, int nrows) {
    const int lane = lane_id_(), wid = wid_;
    f32x4 gg[4];
#pragma unroll
    for (int i = 0; i < 4; ++i) gg[i] = *(const f32x4*)(g + i * 256 + lane * 4);
    for (int r = blockIdx.x * 8 + wid; r < nrows; r += gridDim.x * 8) {
        f32x4 v[4]; float ss = 0.f;
#pragma unroll
        for (int i = 0; i < 4; ++i) { v[i] = *(const f32x4*)(src + (size_t)r * 1024 + i * 256 + lane * 4); ss += v[i][0] * v[i][0] + v[i][1] * v[i][1] + v[i][2] * v[i][2] + v[i][3] * v[i][3]; }
        ss = wave_sum(ss); const float rs = rsqrtf(ss * (1.f / 1024.f) + EPS);
#pragma unroll
        for (int i = 0; i < 4; ++i) { u32x2 o; o.x = cvt_pk_bf16(v[i][0] * rs * gg[i][0], v[i][1] * rs * gg[i][1]); o.y = cvt_pk_bf16(v[i][2] * rs * gg[i][2], v[i][3] * rs * gg[i][3]);
            *(u32x2*)(dst + (size_t)r * 1024 + i * 256 + lane * 4) = o; }
    }
}
template <bool FIRST, bool HASNEXT>
__device__ void row_pass(const int wid_, const float* __restrict__ F, const float* __restrict__ xp, const float* __restrict__ xs, float* out, const float* __restrict__ g_post, float scale,
                         const float* __restrict__ g_next, bf16_t* __restrict__ XN) {
    const int lane = lane_id_(), wid = wid_;
    f32x4 gp[4], gn[4];
#pragma unroll
    for (int i = 0; i < 4; ++i) { gp[i] = *(const f32x4*)(g_post + i * 256 + lane * 4); if (HASNEXT) gn[i] = *(const f32x4*)(g_next + i * 256 + lane * 4); }
    for (int r = blockIdx.x * 8 + wid; r < T; r += gridDim.x * 8) {
        const float* hin = FIRST ? (r < TP ? xp + (size_t)r * 1024 : xs + (size_t)(r - TP) * 1024) : out + (size_t)r * 1024;
        f32x4 f[4], h[4]; float ss = 0.f;
#pragma unroll
        for (int i = 0; i < 4; ++i) { f[i] = *(const f32x4*)(F + (size_t)r * 1024 + i * 256 + lane * 4); h[i] = *(const f32x4*)(hin + i * 256 + lane * 4);
            ss += f[i][0] * f[i][0] + f[i][1] * f[i][1] + f[i][2] * f[i][2] + f[i][3] * f[i][3]; }
        ss = wave_sum(ss); const float rs = rsqrtf(ss * (1.f / 1024.f) + EPS) * scale;
        float s2 = 0.f;
#pragma unroll
        for (int i = 0; i < 4; ++i) { h[i] = h[i] + (f[i] * gp[i]) * rs; *(f32x4*)(out + (size_t)r * 1024 + i * 256 + lane * 4) = h[i];
            s2 += h[i][0] * h[i][0] + h[i][1] * h[i][1] + h[i][2] * h[i][2] + h[i][3] * h[i][3]; }
        if (HASNEXT) { s2 = wave_sum(s2); const float r2 = rsqrtf(s2 * (1.f / 1024.f) + EPS);
#pragma unroll
            for (int i = 0; i < 4; ++i) { u32x2 o; o.x = cvt_pk_bf16(h[i][0] * r2 * gn[i][0], h[i][1] * r2 * gn[i][1]); o.y = cvt_pk_bf16(h[i][2] * r2 * gn[i][2], h[i][3] * r2 * gn[i][3]);
                *(u32x2*)(XN + (size_t)r * 1024 + i * 256 + lane * 4) = o; } }
    }
}

__device__ void sgu_prompt_item(const int wid_, LAS unsigned char* lds, const bf16_t* __restrict__ Z, const bf16_t* __restrict__ Wtril, const float* __restrict__ ln_g, const float* __restrict__ ln_b,
                                const float* __restrict__ b_s, bf16_t* __restrict__ MIXO, float* __restrict__ cv_out, int b, int c) {
    constexpr int LD = 136;
    LAS bf16_t* VT = (LAS bf16_t*)lds;
    const int lane = lane_id_(), wid = wid_, tid = wid * 64 + lane;
    {
        const int row = tid >> 2, qtr = tid & 3;
        const size_t grow = (size_t)b * 2048 + c * 128 + row;
        const bf16_t* vp = Z + grow * 2048 + 512 + qtr * 128;
        u32x4 w[16]; float s1 = 0.f;
#pragma unroll
        for (int i = 0; i < 16; ++i) { w[i] = *(const u32x4*)(vp + i * 8);
            s1 += bflo(w[i].x) + bfhi(w[i].x) + bflo(w[i].y) + bfhi(w[i].y) + bflo(w[i].z) + bfhi(w[i].z) + bflo(w[i].w) + bfhi(w[i].w); }
        s1 += __shfl_xor(s1, 1); s1 += __shfl_xor(s1, 2);
        const float mean = s1 * (1.f / 512.f); float s2 = 0.f;
#pragma unroll
        for (int i = 0; i < 16; ++i) { float d;
            d = bflo(w[i].x) - mean; s2 += d * d; d = bfhi(w[i].x) - mean; s2 += d * d; d = bflo(w[i].y) - mean; s2 += d * d; d = bfhi(w[i].y) - mean; s2 += d * d;
            d = bflo(w[i].z) - mean; s2 += d * d; d = bfhi(w[i].z) - mean; s2 += d * d; d = bflo(w[i].w) - mean; s2 += d * d; d = bfhi(w[i].w) - mean; s2 += d * d; }
        s2 += __shfl_xor(s2, 1); s2 += __shfl_xor(s2, 2);
        const float rstd = rsqrtf(s2 * (1.f / 512.f) + EPS);
        const bool wr_cv = (c == 15);
        float* cvp = cv_out + ((size_t)b * 128 + row) * 512 + qtr * 128;
#pragma unroll
        for (int i = 0; i < 16; ++i) { const int ch = qtr * 128 + i * 8;
            const f32x4 g0 = *(const f32x4*)(ln_g + ch), g1 = *(const f32x4*)(ln_g + ch + 4), b0 = *(const f32x4*)(ln_b + ch), b1 = *(const f32x4*)(ln_b + ch + 4);
            f32x4 y0, y1;
            y0[0] = (bflo(w[i].x) - mean) * rstd * g0[0] + b0[0]; y0[1] = (bfhi(w[i].x) - mean) * rstd * g0[1] + b0[1];
            y0[2] = (bflo(w[i].y) - mean) * rstd * g0[2] + b0[2]; y0[3] = (bfhi(w[i].y) - mean) * rstd * g0[3] + b0[3];
            y1[0] = (bflo(w[i].z) - mean) * rstd * g1[0] + b1[0]; y1[1] = (bfhi(w[i].z) - mean) * rstd * g1[1] + b1[1];
            y1[2] = (bflo(w[i].w) - mean) * rstd * g1[2] + b1[2]; y1[3] = (bfhi(w[i].w) - mean) * rstd * g1[3] + b1[3];
            if (wr_cv) { *(f32x4*)(cvp + i * 8) = y0; *(f32x4*)(cvp + i * 8 + 4) = y1; }
#pragma unroll
            for (int e = 0; e < 4; ++e) { VT[(ch + e) * LD + row] = f2bf(y0[e]); VT[(ch + 4 + e) * LD + row] = f2bf(y1[e]); } }
    }
    __syncthreads();
    {
        const int il = lane & 15, kq = lane >> 4, i = wid * 16 + il;
        const int nks = (wid * 16 + 15) / 32 + 1;
        const size_t grow_i = (size_t)b * 2048 + c * 128 + i;
        for (int h = 0; h < 4; ++h) {
            f32x4 acc[8];
#pragma unroll
            for (int mt = 0; mt < 8; ++mt) acc[mt] = (f32x4){0.f, 0.f, 0.f, 0.f};
            for (int ks = 0; ks < nks; ++ks) {
                const bf16x8 bfrag = *(const bf16x8*)(Wtril + ((size_t)h * 128 + i) * 128 + ks * 32 + kq * 8);
#pragma unroll
                for (int mt = 0; mt < 8; ++mt) { const bf16x8 afrag = *(const LAS bf16x8*)(VT + (h * 128 + mt * 16 + il) * LD + ks * 32 + kq * 8);
                    acc[mt] = __builtin_amdgcn_mfma_f32_16x16x32_bf16(afrag, bfrag, acc[mt], 0, 0, 0); }
            }
            const float bs = b_s[h * 128 + i];
#pragma unroll
            for (int mt = 0; mt < 8; ++mt) { const int dch = h * 128 + mt * 16 + kq * 4;
                const u32x2 uu = *(const u32x2*)(Z + grow_i * 2048 + dch);
                u32x2 o; o.x = cvt_pk_bf16(bflo(uu.x) * (acc[mt][0] + bs), bfhi(uu.x) * (acc[mt][1] + bs)); o.y = cvt_pk_bf16(bflo(uu.y) * (acc[mt][2] + bs), bfhi(uu.y) * (acc[mt][3] + bs));
                *(u32x2*)(MIXO + grow_i * 1024 + dch) = o; }
        }
    }
    __syncthreads();
}

__device__ void sgu_sample_item(const int wid_, LAS unsigned char* lds, const bf16_t* __restrict__ Z, const float* __restrict__ w_s, const float* __restrict__ ln_g, const float* __restrict__ ln_b,
                                const float* __restrict__ b_s, bf16_t* __restrict__ MIXO, float* __restrict__ cv_out, int b) {
    LAS float* red = (LAS float*)lds;
    LAS float* red2 = red + 64;
    const int lane = lane_id_(), wid = wid_, tid = wid * 64 + lane, ch = tid;
    const size_t rowbase = (size_t)TP + b * 8;
    float v[8];
#pragma unroll
    for (int j = 0; j < 8; ++j) { v[j] = bf2f(Z[(rowbase + j) * 2048 + 512 + ch]); const float s = wave_sum(v[j]); if (lane == 0) red[j * 8 + wid] = s; }
    __syncthreads();
    float mean[8];
#pragma unroll
    for (int j = 0; j < 8; ++j) { float s = 0.f;
#pragma unroll
        for (int w = 0; w < 8; ++w) s += red[j * 8 + w];
        mean[j] = s * (1.f / 512.f); const float d = v[j] - mean[j]; const float q = wave_sum(d * d); if (lane == 0) red2[j * 8 + wid] = q; }
    __syncthreads();
    const float gg = ln_g[ch], bb = ln_b[ch];
#pragma unroll
    for (int j = 0; j < 8; ++j) { float s = 0.f;
#pragma unroll
        for (int w = 0; w < 8; ++w) s += red2[j * 8 + w];
        const float rstd = rsqrtf(s * (1.f / 512.f) + EPS);
        v[j] = (v[j] - mean[j]) * rstd * gg + bb;
        cv_out[((size_t)b * 8 + j) * 512 + ch] = v[j]; }
    const int h = ch >> 7;
#pragma unroll
    for (int i = 0; i < 8; ++i) { float s = b_s[h * 128 + i];
#pragma unroll
        for (int j = 0; j <= i; ++j) s += w_s[((size_t)h * 128 + i) * 128 + j] * v[j];
        const float uu = bf2f(Z[(rowbase + i) * 2048 + ch]);
        MIXO[(rowbase + i) * 1024 + ch] = f2bf(uu * s); }
    __syncthreads();
}

template <int NR, bool SAMPLE>
__device__ void conv_item(const int wid_, LAS unsigned char* lds, const bf16_t* __restrict__ Z, const float* __restrict__ state_conv, const float* __restrict__ cw, const float* __restrict__ cb,
                          const float* __restrict__ lng, const float* __restrict__ lnb, bf16_t* __restrict__ MIXO, float* __restrict__ cs_out, size_t rowbase, int b, int t0, int L) {
    LAS float* G = (LAS float*)lds;
    LAS float* red = G + (NR + 30) * 512;
    LAS float* fin = red + NR * 16;
    const int lane = lane_id_(), wid = wid_, tid = wid * 64 + lane;
    for (int rr = tid >> 6; rr < NR + 30; rr += 8) {
        const int c8 = (tid & 63) * 8, t = t0 - 30 + rr;
        f32x4 g0 = (f32x4){0.f, 0.f, 0.f, 0.f}, g1 = g0; bool have = false;
        if (t >= 0) { const size_t row = rowbase + t;
            const u32x4 a = *(const u32x4*)(Z + row * 2048 + 1024 + c8), gt = *(const u32x4*)(Z + row * 2048 + 1536 + c8);
            g0[0] = bflo(a.x) * sigmoidf_(bflo(gt.x)); g0[1] = bfhi(a.x) * sigmoidf_(bfhi(gt.x)); g0[2] = bflo(a.y) * sigmoidf_(bflo(gt.y)); g0[3] = bfhi(a.y) * sigmoidf_(bfhi(gt.y));
            g1[0] = bflo(a.z) * sigmoidf_(bflo(gt.z)); g1[1] = bfhi(a.z) * sigmoidf_(bfhi(gt.z)); g1[2] = bflo(a.w) * sigmoidf_(bflo(gt.w)); g1[3] = bfhi(a.w) * sigmoidf_(bfhi(gt.w));
            have = (rr >= 30);
        } else if (SAMPLE) { const float* sp = state_conv + ((size_t)b * 30 + (30 + t)) * 512 + c8; g0 = *(const f32x4*)sp; g1 = *(const f32x4*)(sp + 4); have = true; }
        const int ci = t + 30 - L;
        if (have && ci >= 0) { float* op = cs_out + ((size_t)b * 30 + ci) * 512 + c8; *(f32x4*)op = g0; *(f32x4*)(op + 4) = g1; }
        *(LAS f32x4*)(G + rr * 512 + c8) = g0; *(LAS f32x4*)(G + rr * 512 + c8 + 4) = g1;
    }
    __syncthreads();
    const int ch = tid;
    float w[31];
#pragma unroll
    for (int k = 0; k < 31; ++k) w[k] = cw[k * 512 + ch];
    const float bias = cb[ch], gg = lng[ch], bb = lnb[ch];
    constexpr int SUB = 8;
#pragma unroll 1
    for (int sub = 0; sub < NR / SUB; ++sub) {
        float acc[SUB];
#pragma unroll
        for (int t = 0; t < SUB; ++t) acc[t] = bias;
        const LAS float* Gs = G + (sub * SUB) * 512 + ch;
#pragma unroll
        for (int rr = 0; rr < SUB + 30; ++rr) { const float x = Gs[rr * 512];
#pragma unroll
            for (int t = 0; t < SUB; ++t) { const int k = rr - t; if (k >= 0 && k <= 30) acc[t] += w[k] * x; } }
#pragma unroll
        for (int t = 0; t < SUB; ++t) { const float s1 = wave_sum(acc[t]), s2 = wave_sum(acc[t] * acc[t]); if (lane == 0) { red[(t * 8 + wid) * 2] = s1; red[(t * 8 + wid) * 2 + 1] = s2; } }
        __syncthreads();
        if (tid < SUB * 2) { const int t = tid >> 1, which = tid & 1; float s = 0.f;
#pragma unroll
            for (int w8 = 0; w8 < 8; ++w8) s += red[(t * 8 + w8) * 2 + which];
            fin[t * 2 + which] = s; }
        __syncthreads();
#pragma unroll
        for (int t = 0; t < SUB; ++t) { const float mean = fin[t * 2] * (1.f / 512.f); const float var = fmaxf(fin[t * 2 + 1] * (1.f / 512.f) - mean * mean, 0.f);
            const float rstd = rsqrtf(var + EPS); const float y = (acc[t] - mean) * rstd * gg + bb;
            MIXO[(rowbase + t0 + sub * SUB + t) * 1024 + 512 + ch] = f2bf(siluf_(y)); }
    }
    __syncthreads();
}

__device__ void attn_sample_item(const int wid_, LAS unsigned char* lds, const bf16_t* __restrict__ Q, const float* __restrict__ CK, const float* __restrict__ CV, bf16_t* __restrict__ AO, int b, int h) {
    LAS float* S = (LAS float*)lds;
    LAS float* Op = S + 8 * 256;
    const int lane = lane_id_(), wid = wid_, tid = wid * 64 + lane;
    {
        const int il = lane & 15, kq = lane >> 4;
        const bf16_t* qrow = Q + ((size_t)TP + b * 8 + (lane & 7)) * 1024 + h * 256 + kq * 8;
        f32x4 acc[2]; acc[0] = (f32x4){0.f, 0.f, 0.f, 0.f}; acc[1] = acc[0];
#pragma unroll 2
        for (int ks = 0; ks < 8; ++ks) { const bf16x8 a = *(const bf16x8*)(qrow + ks * 32);
#pragma unroll
            for (int nt = 0; nt < 2; ++nt) { const int key = wid * 32 + nt * 16 + il;
                const float* kp = CK + (((size_t)b * 256 + key) * 4 + h) * 256 + ks * 32 + kq * 8;
                const f32x4 k0 = *(const f32x4*)kp, k1 = *(const f32x4*)(kp + 4);
                u32x4 pk; pk.x = cvt_pk_bf16(k0[0], k0[1]); pk.y = cvt_pk_bf16(k0[2], k0[3]); pk.z = cvt_pk_bf16(k1[0], k1[1]); pk.w = cvt_pk_bf16(k1[2], k1[3]);
                bf16x8 bb; __builtin_memcpy(&bb, &pk, 16);
                acc[nt] = __builtin_amdgcn_mfma_f32_16x16x32_bf16(a, bb, acc[nt], 0, 0, 0); } }
        if (kq < 2) {
#pragma unroll
            for (int nt = 0; nt < 2; ++nt)
#pragma unroll
                for (int r = 0; r < 4; ++r) S[(kq * 4 + r) * 256 + wid * 32 + nt * 16 + il] = acc[nt][r] * 0.0625f; }
    }
    __syncthreads();
    { f32x4 s = *(const LAS f32x4*)(S + wid * 256 + lane * 4);
      float mx = wave_max(fmaxf(fmaxf(s[0], s[1]), fmaxf(s[2], s[3])));
      s[0] = __expf(s[0] - mx); s[1] = __expf(s[1] - mx); s[2] = __expf(s[2] - mx); s[3] = __expf(s[3] - mx);
      const float sm = wave_sum(s[0] + s[1] + s[2] + s[3]); const float inv = 1.f / sm;
      s = s * inv; *(LAS f32x4*)(S + wid * 256 + lane * 4) = s; }
    __syncthreads();
    {
        f32x4 o[8];
#pragma unroll
        for (int r = 0; r < 8; ++r) o[r] = (f32x4){0.f, 0.f, 0.f, 0.f};
#pragma unroll 4
        for (int kk = 0; kk < 32; ++kk) { const int key = wid * 32 + kk;
            const f32x4 v = *(const f32x4*)(CV + (((size_t)b * 256 + key) * 4 + h) * 256 + lane * 4);
#pragma unroll
            for (int r = 0; r < 8; ++r) { const float p = S[r * 256 + key]; o[r] = o[r] + v * p; } }
#pragma unroll
        for (int r = 0; r < 8; ++r) *(LAS f32x4*)(Op + (wid * 8 + r) * 256 + lane * 4) = o[r];
    }
    __syncthreads();
    { const int r = tid >> 6, d4 = (tid & 63) * 4; f32x4 s = (f32x4){0.f, 0.f, 0.f, 0.f};
#pragma unroll
      for (int w = 0; w < 8; ++w) s = s + *(const LAS f32x4*)(Op + (w * 8 + r) * 256 + d4);
      u32x2 o; o.x = cvt_pk_bf16(s[0], s[1]); o.y = cvt_pk_bf16(s[2], s[3]);
      *(u32x2*)(AO + ((size_t)TP + b * 8 + r) * 1024 + h * 256 + d4) = o; }
    __syncthreads();
}

__device__ __forceinline__ Sched mk_sched(const void* A, const void* B, long tstepA, long tstepB, int nM, int nN, int c) {
    Sched s; s.A = (const char*)A; s.B = (const char*)B; s.tstepA = tstepA; s.tstepB = tstepB; s.zA0 = s.zA1 = s.zB0 = s.zB1 = 0; s.nM = nM; s.nN = nN; s.nZ = 1; s.zsplit = 1; s.G = gridDim.x; s.c = c; return s;
}

template <int K>
__device__ __forceinline__ void run_phase(const Params& p, LAS unsigned char* lds, const int wid_) {
    unsigned char* ws = p.ws;
    float* out = p.out;
    bf16_t* XN = (bf16_t*)(ws + WS_XN); bf16_t* MN = (bf16_t*)(ws + WS_MN); bf16_t* KP = (bf16_t*)(ws + WS_KP); bf16_t* VPT = (bf16_t*)(ws + WS_VPT);
    float* Fb = (float*)(ws + WS_F); bf16_t* Hb = (bf16_t*)(ws + WS_H); bf16_t* Zb = (bf16_t*)(ws + WS_Z); bf16_t* MIXO = (bf16_t*)(ws + WS_MIXO);
    bf16_t* Qb = (bf16_t*)(ws + WS_Q); bf16_t* Pb = (bf16_t*)(ws + WS_P); bf16_t* AO = (bf16_t*)(ws + WS_AO); bf16_t* WS_ = (bf16_t*)(ws + WS_WS);
    const int bid = blockIdx.x, G = gridDim.x;
    (void)XN; (void)MN; (void)KP; (void)VPT; (void)Fb; (void)Hb; (void)Zb; (void)MIXO; (void)Qb; (void)Pb; (void)AO; (void)WS_; (void)bid; (void)G; (void)out;

    if constexpr (K == 0) {
        transpose_w(wid_, lds, p.in[7], (bf16_t*)(ws + WS_WGU1), 1024, 4096);
        transpose_w(wid_, lds, p.in[8], (bf16_t*)(ws + WS_WGU1) + 4096ull * 1024, 1024, 4096);
        transpose_w(wid_, lds, p.in[9], (bf16_t*)(ws + WS_WD1), 4096, 1024);
        transpose_w(wid_, lds, p.in[31], (bf16_t*)(ws + WS_WGU2), 1024, 4096);
        transpose_w(wid_, lds, p.in[32], (bf16_t*)(ws + WS_WGU2) + 4096ull * 1024, 1024, 4096);
        transpose_w(wid_, lds, p.in[33], (bf16_t*)(ws + WS_WD2), 4096, 1024);
        transpose_w(wid_, lds, p.in[12], (bf16_t*)(ws + WS_WIN), 1024, 2048);
        transpose_w(wid_, lds, p.in[21], (bf16_t*)(ws + WS_WOUT), 1024, 1024);
        transpose_w(wid_, lds, p.in[25], (bf16_t*)(ws + WS_WQ), 1024, 1024);
        transpose_w(wid_, lds, p.in[26], (bf16_t*)(ws + WS_WKV), 1024, 1024);
        transpose_w(wid_, lds, p.in[27], (bf16_t*)(ws + WS_WKV) + 1024ull * 1024, 1024, 1024);
        transpose_w(wid_, lds, p.in[28], (bf16_t*)(ws + WS_WO), 1024, 1024);
        for (int e = bid * NTHR + (wid_ * 64 + lane_id_()); e < 4 * 128 * 128; e += G * NTHR) { const int i = (e >> 7) & 127, j = e & 127; WS_[e] = (j <= i) ? f2bf(p.in[15][e]) : (bf16_t)0; }
        norm_rows(wid_, p.in[0], p.in[6], XN, TP);
        norm_rows(wid_, p.in[1], p.in[6], XN + (size_t)TP * 1024, TS);
        norm_rows(wid_, p.in[2], p.in[23], MN, 2048);
    }
    if constexpr (K == 1) {
        { GemmP g{1024, 1024u, 1024u, (size_t)128 * 1024 * 2, (size_t)4096 * 1024 * 2};
          Sched S = mk_sched(XN, ws + WS_WGU1, 256l * 1024 * 2, 128l * 1024 * 2, T / 256, 32, bid);
          EpiSilu E{Hb, FF}; gemm_phase(wid_, lds, g, S, E); }
        { GemmP g{1024, 1024u, 1024u, (size_t)128 * 1024 * 2, (size_t)128 * 1024 * 2};
          Sched S = mk_sched(MN, ws + WS_WKV, 256l * 1024 * 2, 256l * 1024 * 2, 8, 8, (bid + G - (G / 2)) % G);
          EpiKV E{out + O_MK, out + O_MV, KP, VPT}; gemm_phase(wid_, lds, g, S, E); }
    }
    if constexpr (K == 2) {
        GemmP g{4096, 4096u, 4096u, (size_t)128 * 4096 * 2, (size_t)128 * 4096 * 2};
        Sched S = mk_sched(Hb, ws + WS_WD1, 256l * 4096 * 2, 256l * 4096 * 2, T / 256, 4, bid);
        EpiF32 E{Fb, 1024}; gemm_phase(wid_, lds, g, S, E);
    }
    if constexpr (K == 3) row_pass<true, true>(wid_, Fb, p.in[0], p.in[1], out, p.in[10], 0.5f, p.in[11], XN);
    if constexpr (K == 4) {
        GemmP g{1024, 1024u, 1024u, (size_t)128 * 1024 * 2, (size_t)128 * 1024 * 2};
        Sched S = mk_sched(XN, ws + WS_WIN, 256l * 1024 * 2, 256l * 1024 * 2, T / 256, 8, bid);
        EpiBf16 E{Zb, 2048, 0, 0, 1}; gemm_phase(wid_, lds, g, S, E);
    }
    if constexpr (K == 5) {
        const int bid2 = (bid + G - G / 2) % G;
        for (int it = bid; it < 128; it += G) sgu_prompt_item(wid_, lds, Zb, WS_, p.in[13], p.in[14], p.in[16], MIXO, out + O_CVP, it >> 4, it & 15);
        for (int b = bid2; b < 128; b += G) sgu_sample_item(wid_, lds, Zb, p.in[15], p.in[13], p.in[14], p.in[16], MIXO, out + O_CVS, b);
        for (int b = bid2; b < 128; b += G) conv_item<8, true>(wid_, lds, Zb, p.in[5], p.in[17], p.in[18], p.in[19], p.in[20], MIXO, out + O_CSS, (size_t)TP + b * 8, b, 0, 8);
        for (int j = bid; j < 512; j += G) conv_item<32, false>(wid_, lds, Zb, nullptr, p.in[17], p.in[18], p.in[19], p.in[20], MIXO, out + O_CSP, (size_t)(j >> 6) * 2048, j >> 6, (j & 63) * 32, 2048);
    }
    if constexpr (K == 6) {
        GemmP g{1024, 1024u, 1024u, (size_t)128 * 1024 * 2, (size_t)128 * 1024 * 2};
        Sched S = mk_sched(MIXO, ws + WS_WOUT, 256l * 1024 * 2, 256l * 1024 * 2, T / 256, 4, bid);
        EpiF32 E{Fb, 1024}; gemm_phase(wid_, lds, g, S, E);
    }
    if constexpr (K == 7) row_pass<false, true>(wid_, Fb, nullptr, nullptr, out, p.in[22], 1.0f, p.in[24], XN);
    if constexpr (K == 8) {
        GemmP g{1024, 1024u, 1024u, (size_t)128 * 1024 * 2, (size_t)128 * 1024 * 2};
        Sched S = mk_sched(XN, ws + WS_WQ, 256l * 1024 * 2, 256l * 1024 * 2, T / 256, 4, bid);
        EpiBf16 E{Qb, 1024, 0, 0, 1}; gemm_phase(wid_, lds, g, S, E);
    }
    if constexpr (K == 9) {
        { GemmP g{256, 1024u, 1024u, (size_t)128 * 1024 * 2, (size_t)128 * 1024 * 2};
          Sched S = mk_sched(Qb, KP, 256l * 1024 * 2, 0, 8, 1, bid);
          S.nZ = 32; S.zsplit = 4; S.zA0 = 2048l * 1024 * 2; S.zA1 = 256 * 2; S.zB0 = 256l * 1024 * 2; S.zB1 = 256 * 2;
          EpiSoftmax E{Pb}; gemm_phase(wid_, lds, g, S, E); }
        __syncthreads();
        for (int it = bid; it < 512; it += G) attn_sample_item(wid_, lds, Qb, p.in[3], p.in[4], AO, it >> 2, it & 3);
    }
    if constexpr (K == 10) {
        GemmP g{256, 1024u, 256u, (size_t)128 * 1024 * 2, (size_t)128 * 256 * 2};
        Sched S = mk_sched(Pb, VPT, 256l * 1024 * 2, 0, 8, 1, bid);
        S.nZ = 32; S.zsplit = 4; S.zA0 = 2048l * 1024 * 2; S.zA1 = 256 * 2; S.zB0 = 4l * 256 * 256 * 2; S.zB1 = 256l * 256 * 2;
        EpiBf16 E{AO, 1024, 2048l * 1024, 256, 4}; gemm_phase(wid_, lds, g, S, E);
    }
    if constexpr (K == 11) {
        GemmP g{1024, 1024u, 1024u, (size_t)128 * 1024 * 2, (size_t)128 * 1024 * 2};
        Sched S = mk_sched(AO, ws + WS_WO, 256l * 1024 * 2, 256l * 1024 * 2, T / 256, 4, bid);
        EpiF32 E{Fb, 1024}; gemm_phase(wid_, lds, g, S, E);
    }
    if constexpr (K == 12) row_pass<false, true>(wid_, Fb, nullptr, nullptr, out, p.in[29], 1.0f, p.in[30], XN);
    if constexpr (K == 13) {
        GemmP g{1024, 1024u, 1024u, (size_t)128 * 1024 * 2, (size_t)4096 * 1024 * 2};
        Sched S = mk_sched(XN, ws + WS_WGU2, 256l * 1024 * 2, 128l * 1024 * 2, T / 256, 32, bid);
        EpiSilu E{Hb, FF}; gemm_phase(wid_, lds, g, S, E);
    }
    if constexpr (K == 14) {
        GemmP g{4096, 4096u, 4096u, (size_t)128 * 4096 * 2, (size_t)128 * 4096 * 2};
        Sched S = mk_sched(Hb, ws + WS_WD2, 256l * 4096 * 2, 256l * 4096 * 2, T / 256, 4, bid);
        EpiF32 E{Fb, 1024}; gemm_phase(wid_, lds, g, S, E);
    }
    if constexpr (K == 15) row_pass<false, false>(wid_, Fb, nullptr, nullptr, out, p.in[34], 0.5f, nullptr, XN);
}

template <int K> __global__ void __launch_bounds__(NTHR, 2) phase_kernel(Params p) {
    extern __shared__ __attribute__((aligned(16))) unsigned char shm[];
    const int wid_ = __builtin_amdgcn_readfirstlane((int)(threadIdx.x >> 6));
    run_phase<K>(p, (LAS unsigned char*)shm, wid_);
}

#if SINGLE_LAUNCH
__global__ void __launch_bounds__(NTHR, 2) mega(Params p) {
    extern __shared__ __attribute__((aligned(16))) unsigned char shm[];
    LAS unsigned char* lds = (LAS unsigned char*)shm;
    cg::grid_group grid = cg::this_grid();
    const int wid_ = __builtin_amdgcn_readfirstlane((int)(threadIdx.x >> 6));
    run_phase<0>(p, lds, wid_); grid.sync();
    run_phase<1>(p, lds, wid_); grid.sync();
    run_phase<2>(p, lds, wid_); grid.sync();
    run_phase<3>(p, lds, wid_); grid.sync();
    run_phase<4>(p, lds, wid_); grid.sync();
    run_phase<5>(p, lds, wid_); grid.sync();
    run_phase<6>(p, lds, wid_); grid.sync();
    run_phase<7>(p, lds, wid_); grid.sync();
    run_phase<8>(p, lds, wid_); grid.sync();
    run_phase<9>(p, lds, wid_); grid.sync();
    run_phase<10>(p, lds, wid_); grid.sync();
    run_phase<11>(p, lds, wid_); grid.sync();
    run_phase<12>(p, lds, wid_); grid.sync();
    run_phase<13>(p, lds, wid_); grid.sync();
    run_phase<14>(p, lds, wid_); grid.sync();
    run_phase<15>(p, lds, wid_);
}
#define MAINK mega
#else
#define MAINK phase_kernel<1>
#endif

extern "C" void kernel_launch(void* const* d_in, const int* in_sizes, int n_in, void* d_out, int out_size, void* d_ws, size_t ws_size, hipStream_t stream) {
    static int grid = 0;
    if (grid == 0) {
        int dev = 0, cus = 0, per_cu = 0;
        (void)hipGetDevice(&dev);
        (void)hipDeviceGetAttribute(&cus, hipDeviceAttributeMultiprocessorCount, dev);
        if (hipFuncSetAttribute((const void*)MAINK, hipFuncAttributeMaxDynamicSharedMemorySize, LDS_BYTES) != hipSuccess) fprintf(stderr, "hipFuncSetAttribute failed\n");
#define SETATTR(k) (void)hipFuncSetAttribute((const void*)phase_kernel<k>, hipFuncAttributeMaxDynamicSharedMemorySize, LDS_BYTES)
        SETATTR(0); SETATTR(1); SETATTR(2); SETATTR(3); SETATTR(4); SETATTR(5); SETATTR(6); SETATTR(7); SETATTR(8); SETATTR(9); SETATTR(10); SETATTR(11); SETATTR(12); SETATTR(13); SETATTR(14); SETATTR(15);
        if (hipOccupancyMaxActiveBlocksPerMultiprocessor(&per_cu, (const void*)MAINK, NTHR, LDS_BYTES) != hipSuccess || per_cu < 1) { fprintf(stderr, "occupancy query: %d\n", per_cu); per_cu = 1; }
        (void)hipGetLastError();
        grid = cus * per_cu;
        if (ws_size < WS_END) fprintf(stderr, "workspace too small: %zu < %zu\n", ws_size, (size_t)WS_END);
    }
    Params p{};
    for (int i = 0; i < 35; ++i) p.in[i] = (const float*)d_in[i];
    p.out = (float*)d_out; p.ws = (unsigned char*)d_ws;
#if SINGLE_LAUNCH
    p.ph_lo = 0; p.ph_hi = 16;
    void* args[] = {&p};
    hipError_t e = hipLaunchCooperativeKernel((const void*)MAINK, dim3(grid), dim3(NTHR), args, LDS_BYTES, stream);
    if (e != hipSuccess) fprintf(stderr, "cooperative launch failed: %s (grid %d)\n", hipGetErrorString(e), grid);
#else
#define LAUNCH_PH(k) hipLaunchKernelGGL(phase_kernel<k>, dim3(grid), dim3(NTHR), LDS_BYTES, stream, p)
    LAUNCH_PH(0); LAUNCH_PH(1); LAUNCH_PH(2); LAUNCH_PH(3); LAUNCH_PH(4); LAUNCH_PH(5); LAUNCH_PH(6); LAUNCH_PH(7);
    LAUNCH_PH(8); LAUNCH_PH(9); LAUNCH_PH(10); LAUNCH_PH(11); LAUNCH_PH(12); LAUNCH_PH(13); LAUNCH_PH(14); LAUNCH_PH(15);
#endif
}
```
